# Optimizing an MI355X kernel written in HIP

```python
import jax, jax.numpy as jnp
from jax import lax
import numpy as np

D_MODEL = 1024
BATCH = 8
SEQ = 2048
DEPTH = 1
DEC_BATCH = 128
DEC_SEQ = 4
PAST_LEN = 16384
PAGE_SIZE = 128

MIX_WIDTH = D_MODEL
CONV_CH = MIX_WIDTH // 2
CONV_GROUPS = 8
MLP_CH = MIX_WIDTH - CONV_CH
MLP_HEADS = 8
MLP_HEAD_DIM = MLP_CH // MLP_HEADS
CONV_K = 3
CHUNK = 128
EPS = 1e-6
PROJ_WIDTH = 4 * CONV_CH + 3 * MLP_CH

kernel_name = "hybrid_shortconv_chunkmlp_adaln_step"


def rms_norm(x, g):
    xf = x.astype(jnp.float32)
    out = xf * lax.rsqrt(jnp.mean(xf * xf, axis=-1, keepdims=True) + EPS) * g.astype(jnp.float32)
    return out.astype(x.dtype)


def layer_norm(x, g, b):
    xf = x.astype(jnp.float32)
    mu = jnp.mean(xf, axis=-1, keepdims=True)
    xc = xf - mu
    var = jnp.mean(xc * xc, axis=-1, keepdims=True)
    out = xc * lax.rsqrt(var + EPS) * g.astype(jnp.float32) + b.astype(jnp.float32)
    return out.astype(x.dtype)


def chunk_spatial_mix(v, w_s, b_s):
    bsz, t, _ = v.shape
    n_chunks = -(-t // CHUNK)
    pad = n_chunks * CHUNK - t
    vp = jnp.pad(v, ((0, 0), (0, pad), (0, 0))).reshape(bsz, n_chunks, CHUNK, MLP_HEADS, MLP_HEAD_DIM)
    mask = jnp.tril(jnp.ones((CHUNK, CHUNK), dtype=bool))
    w = jnp.where(mask[None], w_s, jnp.zeros((), w_s.dtype))
    out = jnp.einsum("hts,bnshd->bnthd", w, vp) + b_s.T[None, None, :, :, None]
    return out.reshape(bsz, n_chunks * CHUNK, MLP_CH)[:, :t]


def mixer_layer(x, c, conv_buf, w_ada, b_ada, g_norm, w_in, conv_w, g_v, b_v, w_s, b_s, w_out):
    t = x.shape[1]
    mod = jax.nn.silu(c) @ w_ada + b_ada
    shift, scale, gate = jnp.split(mod[:, None, :], 3, axis=-1)
    h = rms_norm(x, g_norm) * (1 + scale) + shift
    p = h @ w_in
    splits = [CONV_CH, 2 * CONV_CH, 3 * CONV_CH, 4 * CONV_CH,
              4 * CONV_CH + MLP_CH, 4 * CONV_CH + 2 * MLP_CH]
    h_a, b_a, c_a, z_a, u_b, v_b, z_b = jnp.split(p, splits, axis=-1)
    s = c_a * h_a
    s_pad = jnp.concatenate([conv_buf.astype(s.dtype), s], axis=1)
    conv = conv_w[0] * s_pad[:, 0:t]
    for k in range(1, CONV_K):
        conv = conv + conv_w[k] * s_pad[:, k:k + t]
    y_a = b_a * conv * jax.nn.silu(z_a)
    new_buf = s_pad[:, t:]
    v_n = layer_norm(v_b, g_v, b_v)
    y_b = u_b * chunk_spatial_mix(v_n, w_s, b_s) * jax.nn.silu(z_b)
    y = jnp.concatenate([y_a, y_b], axis=-1) @ w_out
    return x + gate * y, new_buf, v_n


def setup_inputs(seed: int = 0) -> dict:
    key = jax.random.key(seed)
    ks = jax.random.split(key, 20)
    f = jnp.float32
    nrm = lambda k, shape: jax.random.normal(k, shape, f)
    inputs = {
        "x_prompt": nrm(ks[0], (BATCH, SEQ, D_MODEL)),
        "x_sample": nrm(ks[1], (DEC_BATCH, DEC_SEQ, D_MODEL)),
        "state_conv": nrm(ks[2], (DEPTH, DEC_BATCH, CONV_K - 1, CONV_CH)),
        "c_prompt": nrm(ks[3], (BATCH, D_MODEL)),
        "c_sample": nrm(ks[4], (DEC_BATCH, D_MODEL)),
        "w_ada": nrm(ks[5], (DEPTH, D_MODEL, 3 * D_MODEL)) * (0.5 * D_MODEL ** -0.5),
        "b_ada": nrm(ks[6], (DEPTH, 3 * D_MODEL)) * 0.02,
        "g_norm": 1.0 + 0.02 * nrm(ks[7], (DEPTH, D_MODEL)),
        "w_in": nrm(ks[8], (DEPTH, D_MODEL, PROJ_WIDTH)) * D_MODEL ** -0.5,
        "conv_w": nrm(ks[9], (DEPTH, CONV_K, CONV_CH)) * CONV_K ** -0.5,
        "g_v": 1.0 + 0.02 * nrm(ks[10], (DEPTH, MLP_CH)),
        "b_v": 0.02 * nrm(ks[11], (DEPTH, MLP_CH)),
        "w_s": nrm(ks[12], (DEPTH, MLP_HEADS, CHUNK, CHUNK)) * CHUNK ** -0.5,
        "b_s": 1.0 + 0.02 * nrm(ks[13], (DEPTH, MLP_HEADS, CHUNK)),
        "w_out": nrm(ks[14], (DEPTH, MIX_WIDTH, D_MODEL)) * MIX_WIDTH ** -0.5,
        "g_final": 1.0 + 0.02 * nrm(ks[15], (D_MODEL,)),
    }
    return inputs


def reference(x_prompt, x_sample, state_conv, c_prompt, c_sample, w_ada, b_ada, g_norm, w_in,
              conv_w, g_v, b_v, w_s, b_s, w_out, g_final):
    hp = x_prompt
    hs = x_sample
    conv_p, conv_s, v_s = [], [], []
    zero_buf = jnp.zeros((x_prompt.shape[0], CONV_K - 1, CONV_CH), x_prompt.dtype)
    for l in range(DEPTH):
        hp, buf_p, _ = mixer_layer(hp, c_prompt, zero_buf, w_ada[l], b_ada[l], g_norm[l], w_in[l],
                                   conv_w[l], g_v[l], b_v[l], w_s[l], b_s[l], w_out[l])
        hs, buf_s, vn_s = mixer_layer(hs, c_sample, state_conv[l], w_ada[l], b_ada[l], g_norm[l], w_in[l],
                                      conv_w[l], g_v[l], b_v[l], w_s[l], b_s[l], w_out[l])
        conv_p.append(buf_p)
        conv_s.append(buf_s)
        v_s.append(vn_s)
    y_prompt = rms_norm(hp, g_final)
    y_sample = rms_norm(hs, g_final)
    new_conv_prompt = jnp.stack(conv_p)
    new_conv_sample = jnp.stack(conv_s)
    new_v_sample = jnp.stack(v_s)
    return (y_prompt, y_sample, new_conv_prompt, new_conv_sample, new_v_sample)
```

```cpp
#include <hip/hip_runtime.h>
#include <cstdio>
namespace pg8 {
#define PG8_LAS __attribute__((address_space(3)))
typedef unsigned short bf16_t;
typedef short bf16x8 __attribute__((ext_vector_type(8)));
typedef float f32x4 __attribute__((ext_vector_type(4)));
typedef unsigned u32x4 __attribute__((ext_vector_type(4)));
constexpr int BM = 256, BK = 64, HALF = 128, HTB = HALF * BK * 2  , STAGE_BYTES = 8 * HTB, NXCD = 8, WGM = 8;

__host__ __device__ __forceinline__ int lds_byte(int r, int c) { const int st = (r >> 4) * 2 + (c >> 5), rr = r & 15, cc = c & 31, ob = rr * 64 + cc * 2; return st * 1024 + (ob ^ (((ob >> 9) & 1) << 5)); }
__host__ __device__ __forceinline__ void stage_rc(int b, int& R, int& C) { const int st = b / 1024, sb = b % 1024, swz = sb ^ (((sb >> 9) & 1) << 5); R = (st >> 1) * 16 + swz / 64; C = (st & 1) * 32 + (swz % 64) / 2; }
__host__ __device__ __forceinline__ int perm32(int rho) { const int n = rho >> 4, i = rho & 15; return 8 * (i >> 2) + 4 * n + (i & 3); }

struct Unit { int pm, pn; };
struct Gemm { const bf16_t* A; const bf16_t* Bt; int M, N, K; };

struct StaticOrder {
    int nM, nN, nwg, G, c;
    __host__ __device__ void init(int M, int N, int G_, int c_) { nM = M / BM; nN = N / BM; nwg = nM * nN; G = G_; c = c_; }
    __host__ __device__ bool next(int i, Unit& u) const {
        const long L = (long)i * G + c; if (L >= nwg) return false;
        int wgid = (int)L; { const int q = nwg / NXCD, r = nwg % NXCD, xcd = wgid % NXCD, off = wgid / NXCD; wgid = (xcd < r ? xcd * (q + 1) : r * (q + 1) + (xcd - r) * q) + off; }
        const int nig = WGM * nN, gid = wgid / nig, fm = gid * WGM, gsz = (nM - fm) < WGM ? (nM - fm) : WGM;
        u.pm = fm + ((wgid % nig) % gsz); u.pn = (wgid % nig) / gsz; return true;
    }
    __device__ __forceinline__ void a_ready(const Unit&) const {}
    __device__ __forceinline__ void done(const Unit&) const {}
};
struct CountedOrder : StaticOrder {
    const unsigned* ready; unsigned need; unsigned* tmo;
    __device__ __forceinline__ void a_ready(const Unit& u) const {
        if (threadIdx.x < 64) {
            const unsigned long long t0 = __builtin_amdgcn_s_memrealtime(); unsigned polls = 0;
            while ((unsigned)__builtin_amdgcn_readfirstlane(__hip_atomic_load(ready + 64 * u.pm, __ATOMIC_RELAXED, __HIP_MEMORY_SCOPE_AGENT)) < need) {
                if ((++polls & 255u) == 0u && __builtin_amdgcn_readfirstlane(__hip_atomic_load(tmo, __ATOMIC_RELAXED, __HIP_MEMORY_SCOPE_AGENT)) != 0u) break;
                if (__builtin_amdgcn_s_memrealtime() - t0 > 2000000ull) {
                    if (threadIdx.x == 0) { unsigned expect = 0u; __hip_atomic_compare_exchange_strong(tmo + 1, &expect, 0x600u | (unsigned)(u.pm & 0xff), __ATOMIC_RELAXED, __ATOMIC_RELAXED, __HIP_MEMORY_SCOPE_AGENT); __hip_atomic_store(tmo, 1u, __ATOMIC_RELAXED, __HIP_MEMORY_SCOPE_AGENT); }
                    break; }
                __builtin_amdgcn_s_sleep(2); }
            __builtin_amdgcn_fence(__ATOMIC_ACQUIRE, "agent");
            asm volatile("s_waitcnt vmcnt(0)" ::: "memory");
        }
#if !defined(BROKEN_HOOK_NO_BARRIER)
        asm volatile("" ::: "memory"); __builtin_amdgcn_s_barrier(); asm volatile("" ::: "memory");
#endif
    }
};

__device__ __forceinline__ unsigned cvt_pk_bf16(float lo, float hi) { unsigned r; asm volatile("v_cvt_pk_bf16_f32 %0, %1, %2" : "=v"(r) : "v"(lo), "v"(hi)); return r; }
typedef float f32x2 __attribute__((ext_vector_type(2)));
__device__ __forceinline__ f32x2 gelu_pk(f32x2 v) {
    const f32x2 av = __builtin_elementwise_abs(v), d = av * 0.2316418882f + 1.0f;
    f32x2 t; t.x = __builtin_amdgcn_rcpf(d.x); t.y = __builtin_amdgcn_rcpf(d.y);
    f32x2 q = t * 0.5307027145f + (-0.7265760135f); q = q * t + 0.7107068705f; q = q * t + (-0.142248368f); q = q * t + 0.127414796f; q = q * t;
    const f32x2 s = (v * v) * (-0.72134752044f);
    f32x2 e; e.x = __builtin_amdgcn_exp2f(s.x); e.y = __builtin_amdgcn_exp2f(s.y);
    const f32x2 m = v * (q * e), r = v - m;
    f32x2 o; o.x = v.x < 0.f ? m.x : r.x; o.y = v.y < 0.f ? m.y : r.y; return o;
}

struct EpiF32 {
    static constexpr bool PERM = false, AFTER_DRAIN = false;
    float* C; int ldc; const float* bias;
    __device__ __forceinline__ void operator()(const f32x4 (&acc)[2][2][4][2], const Unit& u, int wr, int wc, int fr, int fq) const {
        const int row0 = u.pm * BM + wr * 64 + fr, col0 = u.pn * BM + wc * 32 + 4 * fq;
        f32x4 bv[2][2];
#pragma unroll
        for (int bj = 0; bj < 2; ++bj)
#pragma unroll
            for (int n = 0; n < 2; ++n) bv[bj][n] = bias ? *(const f32x4*)(bias + col0 + bj * HALF + n * 16) : (f32x4){0.f, 0.f, 0.f, 0.f};
#pragma unroll
        for (int ai = 0; ai < 2; ++ai)
#pragma unroll
            for (int m = 0; m < 4; ++m) { float* rowp = C + (size_t)(row0 + ai * HALF + m * 16) * ldc + col0;
#pragma unroll
                for (int bj = 0; bj < 2; ++bj)
#pragma unroll
                    for (int n = 0; n < 2; ++n) *(f32x4*)(rowp + bj * HALF + n * 16) = acc[ai][bj][m][n] + bv[bj][n]; }
    }
};
template <int ACT  > struct EpiBf16 {
    static constexpr bool PERM = true, AFTER_DRAIN = false;
    bf16_t* O; int ldc; const float* bias; int split_cols; size_t split_stride;
    __device__ __forceinline__ void operator()(const f32x4 (&acc)[2][2][4][2], const Unit& u, int wr, int wc, int fr, int fq) const {
        const int row0 = u.pm * BM + wr * 64 + fr; int colt = u.pn * BM; bf16_t* base = O;
        if (split_cols) { const int t = colt / split_cols; base += (size_t)t * split_stride; colt -= t * split_cols; }
        const int col0 = colt + wc * 32 + 8 * fq, bcol0 = u.pn * BM + wc * 32 + 8 * fq;
        f32x4 bv[2][2];
#pragma unroll
        for (int bj = 0; bj < 2; ++bj)
#pragma unroll
            for (int n = 0; n < 2; ++n) bv[bj][n] = bias ? *(const f32x4*)(bias + bcol0 + bj * HALF + 4 * n) : (f32x4){0.f, 0.f, 0.f, 0.f};
#pragma unroll
        for (int ai = 0; ai < 2; ++ai)
#pragma unroll
            for (int m = 0; m < 4; ++m) { bf16_t* rowp = base + (size_t)(row0 + ai * HALF + m * 16) * ldc + col0;
#pragma unroll
                for (int bj = 0; bj < 2; ++bj) { f32x4 v0 = acc[ai][bj][m][0] + bv[bj][0], v1 = acc[ai][bj][m][1] + bv[bj][1];
                    if (ACT == 1) { f32x2 a = gelu_pk((f32x2){v0[0], v0[1]}), b = gelu_pk((f32x2){v0[2], v0[3]}), c = gelu_pk((f32x2){v1[0], v1[1]}), d = gelu_pk((f32x2){v1[2], v1[3]});
                        v0 = (f32x4){a.x, a.y, b.x, b.y}; v1 = (f32x4){c.x, c.y, d.x, d.y}; }
                    if (ACT == 2) {
#pragma unroll
                        for (int j = 0; j < 4; ++j) { v0[j] = 0.5f * v0[j] * (1.0f + erff(v0[j] * 0.70710678f)); v1[j] = 0.5f * v1[j] * (1.0f + erff(v1[j] * 0.70710678f)); } }
                    u32x4 w; w.x = cvt_pk_bf16(v0[0], v0[1]); w.y = cvt_pk_bf16(v0[2], v0[3]); w.z = cvt_pk_bf16(v1[0], v1[1]); w.w = cvt_pk_bf16(v1[2], v1[3]);
                    *(u32x4*)(rowp + bj * HALF) = w; } }
    }
};
struct EpiOut {
    static constexpr bool PERM = false, AFTER_DRAIN = false;
    const float* xp; const float* xs; const float* mod; float* out; float* ssq; int mp;
    __device__ __forceinline__ void operator()(const f32x4 (&acc)[2][2][4][2], const Unit& u, int wr, int wc, int fr, int fq) const {
        const int row0 = u.pm * BM + wr * 64 + fr, col0 = u.pn * BM + wc * 32 + 4 * fq;
#pragma unroll
        for (int ai = 0; ai < 2; ++ai)
#pragma unroll
            for (int m = 0; m < 4; ++m) {
                const int r = row0 + ai * HALF + m * 16;
                const float* xrow = r < mp ? xp + (size_t)r * 1024 : xs + (size_t)(r - mp) * 1024;
                const int mr = r < mp ? (r >> 11) : 8 + ((r - mp) >> 2);
                const float* gate = mod + (size_t)mr * 3072 + 2048;
                float* orow = out + (size_t)r * 1024;
                float q = 0.f;
#pragma unroll
                for (int bj = 0; bj < 2; ++bj)
#pragma unroll
                    for (int n = 0; n < 2; ++n) {
                        const int c = col0 + bj * HALF + n * 16;
                        const f32x4 xv = *(const f32x4*)(xrow + c), g = *(const f32x4*)(gate + c);
                        const f32x4 o = xv + g * acc[ai][bj][m][n];
                        *(f32x4*)(orow + c) = o;
                        q += (o[0] * o[0] + o[1] * o[1]) + (o[2] * o[2] + o[3] * o[3]);
                    }
                q += __shfl_xor(q, 16); q += __shfl_xor(q, 32);
                if (fq == 0) ssq[(size_t)r * 16 + u.pn * 4 + wc] = q;
                asm volatile("" ::: "memory");
            }
    }
};
template <class Epi, class Sched, bool STAMP = false>
__device__ __forceinline__ void gemm_phase(PG8_LAS unsigned char* lds, const Gemm g, const Sched& S, const Epi& E, unsigned long long* stamps) {
    const int tid = threadIdx.x, wid = __builtin_amdgcn_readfirstlane(tid >> 6), lane = tid & 63, wr = wid >> 2, wc = wid & 3, fr = lane & 15, fq = lane >> 4;
    const int K = g.K, nt = K / BK;
    int ts_lo = 0, ts_hi = 0, nts = 0; const unsigned long long rt_entry = STAMP ? (unsigned long long)wall_clock64() : 0ull;
#define PG8_STAMP() do { if (STAMP && wid == 0 && nts < 64) { const unsigned long long _c = (unsigned long long)clock64(); \
        ts_lo = (lane == nts) ? (int)(unsigned)_c : ts_lo; ts_hi = (lane == nts) ? (int)(unsigned)(_c >> 32) : ts_hi; ++nts; } } while (0)
    PG8_STAMP();
    unsigned voffA[2], voffB[2];
#pragma unroll
    for (int i = 0; i < 2; ++i) { int R, C; stage_rc(tid * 16 + i * 8192, R, C); const int Rb = Epi::PERM ? ((R & ~31) + perm32(R & 31)) : R;
        voffA[i] = (unsigned)(R * K + C) * 2u; voffB[i] = (unsigned)(Rb * K + C) * 2u; }
    const size_t kstep = (size_t)(BK * 2);
    const size_t hstep = (size_t)HALF * K * 2;
    const size_t tstep = 2 * hstep;
    const unsigned ldsw = (unsigned)wid * 1024u;
    const int aoff = lds_byte(wr * 64 + fr, fq * 8), boff = lds_byte(wc * 32 + fr, fq * 8);
#define PG8_SA(b, h) (((b) * 2 + (h)) * HTB)
#define PG8_SB(b, h) ((4 + (b) * 2 + (h)) * HTB)
#define PG8_STAGE(bufoff, gbase, voff) do { _Pragma("unroll") for (int _i = 0; _i < 2; ++_i) \
        __builtin_amdgcn_global_load_lds((const unsigned*)((const char*)(gbase) + (voff)[_i]), (PG8_LAS unsigned*)(lds + (bufoff) + ldsw + _i * 8192), 16, 0, 0); } while (0)
#define PG8_LDA(dst, b, h) do { _Pragma("unroll") for (int m = 0; m < 4; ++m) _Pragma("unroll") for (int k = 0; k < 2; ++k) dst[m][k] = *(const PG8_LAS bf16x8*)(lds + PG8_SA(b, h) + aoff + m * 2048 + k * 1024); } while (0)
#define PG8_LDB(dst, b, h) do { _Pragma("unroll") for (int n = 0; n < 2; ++n) _Pragma("unroll") for (int k = 0; k < 2; ++k) dst[n][k] = *(const PG8_LAS bf16x8*)(lds + PG8_SB(b, h) + boff + n * 2048 + k * 1024); } while (0)
#define PG8_MMA(ai, bj, At, Bt) do { __builtin_amdgcn_s_setprio(1); _Pragma("unroll") for (int m = 0; m < 4; ++m) _Pragma("unroll") for (int n = 0; n < 2; ++n) _Pragma("unroll") for (int k = 0; k < 2; ++k) \
        acc[ai][bj][m][n] = __builtin_amdgcn_mfma_f32_16x16x32_bf16(Bt[n][k], At[m][k], acc[ai][bj][m][n], 0, 0, 0); __builtin_amdgcn_s_setprio(0); } while (0)
#define PG8_WAIT_V(n) asm volatile("s_waitcnt vmcnt(" #n ")" ::: "memory")
#define PG8_WAIT_L(n) asm volatile("s_waitcnt lgkmcnt(" #n ")" ::: "memory")
#define PG8_BAR __builtin_amdgcn_s_barrier()
#define PG8_SCHED __builtin_amdgcn_sched_barrier(0)
    Unit cur, nxt; int ui = 0;
    if (!S.next(0, cur)) return;
    f32x4 acc[2][2][4][2];
#pragma unroll
    for (int a = 0; a < 2; ++a)
#pragma unroll
        for (int b = 0; b < 2; ++b)
#pragma unroll
            for (int m = 0; m < 4; ++m)
#pragma unroll
                for (int n = 0; n < 2; ++n) acc[a][b][m][n] = (f32x4){0.f, 0.f, 0.f, 0.f};
    bf16x8 At[4][2], B0[2][2], B1[2][2];
    const char* cA = (const char*)g.A + (size_t)cur.pm * tstep; const char* cB = (const char*)g.Bt + (size_t)cur.pn * tstep;
    S.a_ready(cur);
    PG8_STAGE(PG8_SB(0, 0), cB, voffB); PG8_STAGE(PG8_SA(0, 0), cA, voffA); PG8_STAGE(PG8_SB(0, 1), cB + hstep, voffB); PG8_STAGE(PG8_SA(0, 1), cA + hstep, voffA);
    if (wr == 1) PG8_BAR;
    PG8_WAIT_V(4); PG8_BAR;
    PG8_STAGE(PG8_SB(1, 0), cB + kstep, voffB); PG8_STAGE(PG8_SA(1, 0), cA + kstep, voffA); PG8_STAGE(PG8_SB(1, 1), cB + hstep + kstep, voffB);
    PG8_WAIT_V(6); PG8_BAR;
    PG8_STAMP();
    for (;;) {
        const bool has_next = S.next(ui + 1, nxt);
        const char* nA = has_next ? (const char*)g.A + (size_t)nxt.pm * tstep : cA; const char* nB = has_next ? (const char*)g.Bt + (size_t)nxt.pn * tstep : cB;
        for (int t = 0; t < nt; t += 2) {
            const bool last = (t == nt - 2);
            const char* a1 = cA + (size_t)(t + 1) * kstep;
            const char* a2 = last ? nA : cA + (size_t)(t + 2) * kstep; const char* b2 = last ? nB : cB + (size_t)(t + 2) * kstep;
            const char* a3 = a2 + kstep; const char* b3 = b2 + kstep;
            if (last && has_next) S.a_ready(nxt);
            PG8_LDB(B0, 0, 0); PG8_SCHED; PG8_LDA(At, 0, 0); PG8_STAGE(PG8_SA(1, 1), a1 + hstep, voffA);
            PG8_WAIT_L(8); PG8_BAR; PG8_WAIT_L(0); PG8_MMA(0, 0, At, B0); PG8_BAR; PG8_SCHED;
            PG8_LDB(B1, 0, 1); PG8_STAGE(PG8_SB(0, 0), b2, voffB);
            PG8_BAR; PG8_WAIT_L(0); PG8_MMA(0, 1, At, B1); PG8_BAR;
            PG8_LDA(At, 0, 1); PG8_STAGE(PG8_SA(0, 0), a2, voffA);
            PG8_BAR; PG8_WAIT_L(0); PG8_MMA(1, 0, At, B0); PG8_BAR; PG8_SCHED;
            PG8_STAGE(PG8_SB(0, 1), b2 + hstep, voffB);
            PG8_WAIT_V(6); PG8_BAR; PG8_MMA(1, 1, At, B1); PG8_BAR;
            PG8_LDB(B0, 1, 0); PG8_SCHED; PG8_LDA(At, 1, 0); PG8_STAGE(PG8_SA(0, 1), a2 + hstep, voffA);
            PG8_WAIT_L(8); PG8_BAR; PG8_WAIT_L(0); PG8_MMA(0, 0, At, B0); PG8_BAR; PG8_SCHED;
            PG8_LDB(B1, 1, 1); PG8_STAGE(PG8_SB(1, 0), b3, voffB);
            PG8_BAR; PG8_WAIT_L(0); PG8_MMA(0, 1, At, B1); PG8_BAR;
            PG8_LDA(At, 1, 1); PG8_STAGE(PG8_SA(1, 0), a3, voffA);
            PG8_BAR; PG8_WAIT_L(0); PG8_MMA(1, 0, At, B0); PG8_BAR; PG8_SCHED;
            PG8_STAGE(PG8_SB(1, 1), b3 + hstep, voffB);
            PG8_WAIT_V(6); PG8_BAR; PG8_MMA(1, 1, At, B1); PG8_BAR;
        }
        PG8_STAMP();
        if constexpr (!Epi::AFTER_DRAIN) { E(acc, cur, wr, wc, fr, fq); S.done(cur); }
        PG8_STAMP();
        if (!has_next) break;
#pragma unroll
        for (int a = 0; a < 2; ++a)
#pragma unroll
            for (int b = 0; b < 2; ++b)
#pragma unroll
                for (int m = 0; m < 4; ++m)
#pragma unroll
                    for (int n = 0; n < 2; ++n) acc[a][b][m][n] = (f32x4){0.f, 0.f, 0.f, 0.f};
        cur = nxt; cA = nA; cB = nB; ++ui;
    }
    PG8_WAIT_V(0);
    if (wr == 0) PG8_BAR;
    PG8_BAR;
    if constexpr (Epi::AFTER_DRAIN) { E.fused(acc, cur, wr, wc, fr, fq, lds, wid, lane); S.done(cur); }
    PG8_STAMP();
    if (STAMP && wid == 0) { stamps[lane] = lane < nts ? (((unsigned long long)(unsigned)ts_hi << 32) | (unsigned)ts_lo) : 0ull;
        if (lane == 62) stamps[62] = rt_entry; if (lane == 63) stamps[63] = (unsigned long long)wall_clock64(); }
#undef PG8_STAMP
#undef PG8_SA
#undef PG8_SB
#undef PG8_STAGE
#undef PG8_LDA
#undef PG8_LDB
#undef PG8_MMA
#undef PG8_WAIT_V
#undef PG8_WAIT_L
#undef PG8_BAR
#undef PG8_SCHED
}
}

#define LAS __attribute__((address_space(3)))
typedef unsigned short bf16;
typedef pg8::bf16x8 bf16x8;
typedef pg8::f32x4 f32x4;
typedef pg8::u32x4 u32x4;
typedef unsigned u32x2 __attribute__((ext_vector_type(2)));

constexpr int D = 1024, NB = 8, SEQ = 2048, NSQ = 128, DSQ = 4, MP = NB * SEQ, MS = NSQ * DSQ, MT = MP + MS, PW = 3584, CC = 512, NMOD = NB + NSQ;
constexpr float EPS = 1e-6f;
constexpr int NWAVES = 8, NTHR = 512;
constexpr int LDS_BYTES = 135168, MISC_OFF = LDS_BYTES - 64;
constexpr int VPITCH = 1028;
constexpr size_t WS_CTL = 0, WS_MOD = 65536, WS_W1T = 2097152, WS_W2T = 9437184, WS_WSB = 11534336, WS_SSQ = 11796480,
                 WS_H = 16777216, WS_YC = 54525952, WS_P = 100663296, WS_END = WS_P + (size_t)MT * PW * 2;
constexpr size_t O_Y = 0, O_NCP = (size_t)MT * D, O_NCS = O_NCP + (size_t)NB * 2 * CC, O_NVS = O_NCS + (size_t)NSQ * 2 * CC;

#define XB_TMO      128
#define XB_XCNT(j)  (256  + 64 * (j))
#define XB_XSUB(j)  (1280 + 64 * (j))
#define XB_XGEN(j)  (2304 + 64 * (j))
#define XB_TOP      3328
#define XB_TOPGEN   3392
#define XCD_BAR_WORDS 3456
#define XB_SPIN_CAP (1u << 18)
__device__ __forceinline__ unsigned xb_ld(unsigned* p)              { return __hip_atomic_load(p, __ATOMIC_RELAXED, __HIP_MEMORY_SCOPE_AGENT); }
__device__ __forceinline__ unsigned xb_add(unsigned* p, unsigned v) { return __hip_atomic_fetch_add(p, v, __ATOMIC_RELAXED, __HIP_MEMORY_SCOPE_AGENT); }
__device__ __forceinline__ unsigned xb_xcc_id() { return (unsigned)__builtin_amdgcn_s_getreg((3 << 11) | 20) & 0xFu; }
#define XB_SPIN(cond, bar) do { unsigned _sp = 0; while (cond) { __builtin_amdgcn_s_sleep(1); \
    if ((++_sp & 255u) == 0u) { if (xb_ld(&(bar)[XB_TMO])) break; if (_sp > XB_SPIN_CAP) { atomicAdd(&(bar)[XB_TMO], 1u); break; } } } } while (0)
struct XcdBarrier { unsigned* bar; unsigned x; volatile LAS unsigned* st; };
__device__ __forceinline__ XcdBarrier xcd_barrier_post(unsigned* bar, volatile LAS unsigned* st) {
    XcdBarrier b; b.bar = bar; b.x = xb_xcc_id(); b.st = st;
    if (threadIdx.x == 0) (void)xb_add(&bar[XB_XCNT(b.x)], 1u);
    return b;
}
__device__ __forceinline__ void xcd_barrier_complete(unsigned* bar, unsigned x, unsigned& nloc, unsigned& nx) {
    const unsigned G = gridDim.x * gridDim.y * gridDim.z;
    unsigned sum, cnt, mine, sp = 0u;
    for (;;) {
        sum = 0u; cnt = 0u; mine = 0u;
#pragma unroll
        for (unsigned j = 0; j < 16; ++j) { const unsigned c = xb_ld(&bar[XB_XCNT(j)]); sum += c; cnt += (c > 0u) ? 1u : 0u; mine = (j == x) ? c : mine; }
        if (sum == G) break;
        __builtin_amdgcn_s_sleep(1);
        if ((++sp & 255u) == 0u) { if (xb_ld(&bar[XB_TMO])) break; if (sp > XB_SPIN_CAP) { atomicAdd(&bar[XB_TMO], 1u); break; } }
    }
    nloc = mine > 0u ? mine : 1u; nx = cnt > 0u ? cnt : 1u;
}
__device__ __forceinline__ void xcd_barrier(const XcdBarrier& b) {
    asm volatile("s_waitcnt vmcnt(0)" ::: "memory");
    __syncthreads();
    if (threadIdx.x == 0) {
        unsigned* bar = b.bar;
        __builtin_amdgcn_s_waitcnt(0);
        unsigned nloc = b.st[0], nx = b.st[1];
        if (nloc == 0u) { xcd_barrier_complete(bar, b.x, nloc, nx); b.st[0] = nloc; b.st[1] = nx; }
        const unsigned old = xb_add(&bar[XB_XSUB(b.x)], 1u);
        const unsigned gen = old / nloc;
        if (old + 1u == (gen + 1u) * nloc) {
            __builtin_amdgcn_fence(__ATOMIC_RELEASE, "agent");
            asm volatile("s_waitcnt vmcnt(0)" ::: "memory");
            const unsigned og = xb_add(&bar[XB_TOP], 1u);
            const unsigned tg = og / nx;
            if (og + 1u == (tg + 1u) * nx) xb_add(&bar[XB_TOPGEN], 1u);
            else XB_SPIN(xb_ld(&bar[XB_TOPGEN]) == tg, bar);
            __builtin_amdgcn_fence(__ATOMIC_ACQUIRE, "agent");
            xb_add(&bar[XB_XGEN(b.x)], 1u);
            asm volatile("s_waitcnt vmcnt(0)" ::: "memory");
        } else {
            XB_SPIN(xb_ld(&bar[XB_XGEN(b.x)]) == gen, bar);
            __builtin_amdgcn_fence(__ATOMIC_ACQUIRE, "agent");
            asm volatile("s_waitcnt vmcnt(0)" ::: "memory");
        }
    }
    __syncthreads();
}

__device__ __forceinline__ float wave_sum(float v) {
#pragma unroll
    for (int o = 1; o < 64; o <<= 1) v += __shfl_xor(v, o);
    return v;
}
__device__ __forceinline__ unsigned pk2(float lo, float hi) { return pg8::cvt_pk_bf16(lo, hi); }
__device__ __forceinline__ float bflo(unsigned w) { return __uint_as_float(w << 16); }
__device__ __forceinline__ float bfhi(unsigned w) { return __uint_as_float(w & 0xffff0000u); }
__device__ __forceinline__ float silu(float x) { return x * __builtin_amdgcn_rcpf(1.0f + __expf(-x)); }
__device__ __forceinline__ void unpack8(const u32x4 r, float (&x)[8]) {
    x[0] = bflo(r.x); x[1] = bfhi(r.x); x[2] = bflo(r.y); x[3] = bfhi(r.y); x[4] = bflo(r.z); x[5] = bfhi(r.z); x[6] = bflo(r.w); x[7] = bfhi(r.w);
}
__device__ __forceinline__ u32x4 pack8(const float (&x)[8]) { u32x4 o; o.x = pk2(x[0], x[1]); o.y = pk2(x[2], x[3]); o.z = pk2(x[4], x[5]); o.w = pk2(x[6], x[7]); return o; }
__device__ __forceinline__ void ld8f(const float* p, float (&x)[8]) { const f32x4 a = *(const f32x4*)p, b = *(const f32x4*)(p + 4); x[0] = a[0]; x[1] = a[1]; x[2] = a[2]; x[3] = a[3]; x[4] = b[0]; x[5] = b[1]; x[6] = b[2]; x[7] = b[3]; }
__device__ __forceinline__ void st8f(float* p, const float (&x)[8]) { *(f32x4*)p = (f32x4){x[0], x[1], x[2], x[3]}; *(f32x4*)(p + 4) = (f32x4){x[4], x[5], x[6], x[7]}; }

struct Args {
    const float *x_prompt, *x_sample, *state_conv, *c_prompt, *c_sample, *w_ada, *b_ada, *g_norm, *w_in, *conv_w, *g_v, *b_v, *w_s, *b_s, *w_out, *g_final;
    float* out; unsigned char* ws; int ph_lo, ph_hi;
};

__device__ __forceinline__ void p0_mod_item(const Args& a, LAS unsigned char* lds, int item, int tid) {
    const int lane = tid & 63, w = tid >> 6, fr = lane & 15, fq = lane >> 4, n0 = item * 16;
    LAS float* red = (LAS float*)lds;
    f32x4 acc[9];
#pragma unroll
    for (int i = 0; i < 9; ++i) acc[i] = (f32x4){0.f, 0.f, 0.f, 0.f};
#pragma unroll 1
    for (int kk = 0; kk < 4; ++kk) {
        const int k0 = (4 * w + kk) * 32 + 8 * fq;
        float bw[8];
#pragma unroll
        for (int j = 0; j < 8; ++j) bw[j] = a.w_ada[(size_t)(k0 + j) * 3072 + n0 + fr];
        const u32x4 bp = pack8(bw);
        const bf16x8 bf = __builtin_bit_cast(bf16x8, bp);
#pragma unroll
        for (int mt = 0; mt < 9; ++mt) {
            const int row = 16 * mt + fr;
            float cv[8];
#pragma unroll
            for (int j = 0; j < 8; ++j) cv[j] = 0.f;
            if (row < NMOD) { const float* cp = row < NB ? a.c_prompt + (size_t)row * D : a.c_sample + (size_t)(row - NB) * D; ld8f(cp + k0, cv); }
#pragma unroll
            for (int j = 0; j < 8; ++j) cv[j] = silu(cv[j]);
            const u32x4 ap = pack8(cv);
            acc[mt] = __builtin_amdgcn_mfma_f32_16x16x32_bf16(__builtin_bit_cast(bf16x8, ap), bf, acc[mt], 0, 0, 0);
        }
    }
#pragma unroll
    for (int mt = 0; mt < 9; ++mt)
#pragma unroll
        for (int j = 0; j < 4; ++j) red[((w * 9 + mt) * 4 + j) * 64 + lane] = acc[mt][j];
    __syncthreads();
    float* mod = (float*)(a.ws + WS_MOD);
    for (int o = tid; o < 9 * 4 * 64; o += NTHR) {
        float s = 0.f;
#pragma unroll
        for (int w8 = 0; w8 < 8; ++w8) s += red[w8 * 2304 + o];
        const int l = o & 63, mj = o >> 6, mt = mj >> 2, j = mj & 3, row = 16 * mt + 4 * (l >> 4) + j, col = n0 + (l & 15);
        if (row < NMOD) mod[(size_t)row * 3072 + col] = s + a.b_ada[col];
    }
    __syncthreads();
}
__device__ __forceinline__ void p0_transpose_item(const float* W, int K, int N, bf16* WT, LAS float* scr, int item, int lane) {
    const int nblk = N / 32, kb = item / nblk, nb = item % nblk, k0 = 64 * kb, n0 = 32 * nb;
#pragma unroll 8
    for (int i = 0; i < 32; ++i) { const int kk = 2 * i + (lane >> 5); scr[kk * 33 + (lane & 31)] = W[(size_t)(k0 + kk) * N + n0 + (lane & 31)]; }
    asm volatile("s_waitcnt lgkmcnt(0)" ::: "memory");
    const int c = lane & 7;
#pragma unroll
    for (int j = 0; j < 4; ++j) { const int n = (lane >> 3) + 8 * j; const LAS float* s = scr + (8 * c) * 33 + n;
        u32x4 o; o.x = pk2(s[0 * 33], s[1 * 33]); o.y = pk2(s[2 * 33], s[3 * 33]); o.z = pk2(s[4 * 33], s[5 * 33]); o.w = pk2(s[6 * 33], s[7 * 33]);
        *(u32x4*)(WT + (size_t)(n0 + n) * K + k0 + 8 * c) = o; }
    asm volatile("s_waitcnt lgkmcnt(0)" ::: "memory");
}
__device__ __forceinline__ void phase0(const Args& a, LAS unsigned char* lds, int bid, int G, int tid) {
    const int lane = tid & 63, w = tid >> 6;
    for (int it = bid; it < 192; it += G) p0_mod_item(a, lds, it, tid);
    LAS float* scr = (LAS float*)(lds + w * 8448);
    const int NGW = G * NWAVES; int gw = ((bid + G - (192 % G)) % G) * NWAVES + w;
    constexpr int I_1 = (D / 64) * (PW / 32), I_2 = (D / 64) * (D / 32);
    for (int it = gw; it < I_1 + I_2; it += NGW) {
        if (it < I_1) p0_transpose_item(a.w_in, D, PW, (bf16*)(a.ws + WS_W1T), scr, it, lane);
        else p0_transpose_item(a.w_out, D, D, (bf16*)(a.ws + WS_W2T), scr, it - I_1, lane);
    }
    bf16* wsb = (bf16*)(a.ws + WS_WSB);
    for (int i = bid * NTHR + tid; i < 8 * 128 * 128 / 8; i += G * NTHR) {
        const int e = i * 8, t = (e >> 7) & 127, s0 = e & 127; float x[8]; ld8f(a.w_s + e, x);
#pragma unroll
        for (int j = 0; j < 8; ++j) x[j] = (s0 + j <= t) ? x[j] : 0.f;
        *(u32x4*)(wsb + e) = pack8(x);
    }
}

__device__ __forceinline__ void phase1(const Args& a, int bid, int G, int tid) {
    const int lane = tid & 63, w = tid >> 6, NGW = G * NWAVES;
    const float* mod = (const float*)(a.ws + WS_MOD); bf16* H = (bf16*)(a.ws + WS_H);
    for (int m = bid * NWAVES + w; m < MT; m += NGW) {
        const float* xr = m < MP ? a.x_prompt + (size_t)m * D : a.x_sample + (size_t)(m - MP) * D;
        const int r = m < MP ? (m >> 11) : NB + ((m - MP) >> 2);
        const float* md = mod + (size_t)r * 3072;
        f32x4 v[4]; float ss = 0.f;
#pragma unroll
        for (int j = 0; j < 4; ++j) { v[j] = ((const f32x4*)xr)[lane + 64 * j]; ss += (v[j][0] * v[j][0] + v[j][1] * v[j][1]) + (v[j][2] * v[j][2] + v[j][3] * v[j][3]); }
        const float rstd = 1.0f / sqrtf(wave_sum(ss) * (1.0f / D) + EPS);
#pragma unroll
        for (int j = 0; j < 4; ++j) {
            const f32x4 g = ((const f32x4*)a.g_norm)[lane + 64 * j], sh = ((const f32x4*)md)[lane + 64 * j], sc = ((const f32x4*)(md + D))[lane + 64 * j];
            const f32x4 hv = v[j] * rstd * g * (sc + 1.0f) + sh;
            u32x2 o; o.x = pk2(hv[0], hv[1]); o.y = pk2(hv[2], hv[3]);
            ((u32x2*)(H + (size_t)m * D))[lane + 64 * j] = o;
        }
    }
}

__device__ __forceinline__ void conv_rows(const Args& a, const bf16* P, bf16* YC, int m_start, int n, float (&s1)[8], float (&s2)[8], int lane, bool sample, int seq) {
    const int c0 = 8 * lane;
    float w0[8], w1[8], w2[8]; ld8f(a.conv_w + c0, w0); ld8f(a.conv_w + CC + c0, w1); ld8f(a.conv_w + 2 * CC + c0, w2);
#pragma unroll 2
    for (int i = 0; i < n; ++i) {
        const int m = m_start + i; const bf16* pr = P + (size_t)m * PW + c0;
        const u32x4 rh = *(const u32x4*)pr, rb = *(const u32x4*)(pr + 512), rc = *(const u32x4*)(pr + 1024), rz = *(const u32x4*)(pr + 1536);
        float h[8], b[8], c[8], z[8], s[8], y[8]; unpack8(rh, h); unpack8(rb, b); unpack8(rc, c); unpack8(rz, z);
#pragma unroll
        for (int j = 0; j < 8; ++j) { s[j] = c[j] * h[j]; const float cv = w0[j] * s2[j] + w1[j] * s1[j] + w2[j] * s[j]; y[j] = b[j] * cv * silu(z[j]); }
        *(u32x4*)(YC + (size_t)m * D + c0) = pack8(y);
        if (!sample) { const int t = m & (SEQ - 1); if (t >= SEQ - 2) st8f(a.out + O_NCP + ((size_t)(m >> 11) * 2 + (t - (SEQ - 2))) * CC + c0, s); }
        else if (i >= DSQ - 2) st8f(a.out + O_NCS + ((size_t)seq * 2 + (i - (DSQ - 2))) * CC + c0, s);
#pragma unroll
        for (int j = 0; j < 8; ++j) { s2[j] = s1[j]; s1[j] = s[j]; }
    }
}
__device__ __forceinline__ void mixA_item(const Args& a, int item, int tid) {
    const int lane = tid & 63, w = tid >> 6, c0 = 8 * lane, m_start = item * 64 + w * 8;
    const bf16* P = (const bf16*)(a.ws + WS_P); bf16* YC = (bf16*)(a.ws + WS_YC);
    float s1[8], s2[8];
    if ((m_start & (SEQ - 1)) == 0) {
#pragma unroll
        for (int j = 0; j < 8; ++j) { s1[j] = 0.f; s2[j] = 0.f; }
    } else {
        const bf16* p1 = P + (size_t)(m_start - 1) * PW + c0; const bf16* p2 = P + (size_t)(m_start - 2) * PW + c0;
        float h[8], c[8]; unpack8(*(const u32x4*)p1, h); unpack8(*(const u32x4*)(p1 + 1024), c);
#pragma unroll
        for (int j = 0; j < 8; ++j) s1[j] = c[j] * h[j];
        unpack8(*(const u32x4*)p2, h); unpack8(*(const u32x4*)(p2 + 1024), c);
#pragma unroll
        for (int j = 0; j < 8; ++j) s2[j] = c[j] * h[j];
    }
    conv_rows(a, P, YC, m_start, 8, s1, s2, lane, false, 0);
}
__device__ __forceinline__ void mixS_item(const Args& a, int item, int tid) {
    const int lane = tid & 63, w = tid >> 6, c0 = 8 * lane, q = item * 8 + w, m0 = MP + 4 * q;
    const bf16* P = (const bf16*)(a.ws + WS_P); bf16* YC = (bf16*)(a.ws + WS_YC);
    float s1[8], s2[8]; ld8f(a.state_conv + ((size_t)q * 2 + 0) * CC + c0, s2); ld8f(a.state_conv + ((size_t)q * 2 + 1) * CC + c0, s1);
    conv_rows(a, P, YC, m0, DSQ, s1, s2, lane, true, q);
    float gv[8], bv[8]; ld8f(a.g_v + c0, gv); ld8f(a.b_v + c0, bv);
    float vn[4][8];
#pragma unroll
    for (int t = 0; t < 4; ++t) {
        float x[8]; unpack8(*(const u32x4*)(P + (size_t)(m0 + t) * PW + 2560 + c0), x);
        float s = 0.f;
#pragma unroll
        for (int j = 0; j < 8; ++j) s += x[j];
        const float mean = wave_sum(s) * (1.0f / CC); float qq = 0.f;
#pragma unroll
        for (int j = 0; j < 8; ++j) { x[j] -= mean; qq += x[j] * x[j]; }
        const float rstd = 1.0f / sqrtf(wave_sum(qq) * (1.0f / CC) + EPS);
#pragma unroll
        for (int j = 0; j < 8; ++j) vn[t][j] = x[j] * rstd * gv[j] + bv[j];
        st8f(a.out + O_NVS + ((size_t)q * 4 + t) * CC + c0, vn[t]);
    }
    const int hh = lane >> 3;
#pragma unroll
    for (int t = 0; t < 4; ++t) {
        float o[8]; const float bias = a.b_s[hh * 128 + t];
#pragma unroll
        for (int j = 0; j < 8; ++j) o[j] = bias;
#pragma unroll
        for (int s = 0; s <= t; ++s) { const float wv = a.w_s[((size_t)hh * 128 + t) * 128 + s];
#pragma unroll
            for (int j = 0; j < 8; ++j) o[j] += wv * vn[s][j]; }
        const bf16* pr = P + (size_t)(m0 + t) * PW + c0; float u[8], z[8]; unpack8(*(const u32x4*)(pr + 2048), u); unpack8(*(const u32x4*)(pr + 3072), z);
#pragma unroll
        for (int j = 0; j < 8; ++j) o[j] = u[j] * silu(z[j]) * o[j];
        *(u32x4*)(YC + (size_t)(m0 + t) * D + CC + c0) = pack8(o);
    }
}
__device__ __forceinline__ void mixB_item(const Args& a, LAS unsigned char* lds, int item, int tid) {
    const int lane = tid & 63, w = tid >> 6, fr = lane & 15, fq = lane >> 4, m0 = item * 128;
    const bf16* P = (const bf16*)(a.ws + WS_P); bf16* YC = (bf16*)(a.ws + WS_YC); const bf16* WSB = (const bf16*)(a.ws + WS_WSB);
    {
        float gv[8], bv[8];
#pragma unroll
        for (int q = 0; q < 4; ++q) { gv[2 * q] = a.g_v[2 * lane + 128 * q]; gv[2 * q + 1] = a.g_v[2 * lane + 128 * q + 1]; bv[2 * q] = a.b_v[2 * lane + 128 * q]; bv[2 * q + 1] = a.b_v[2 * lane + 128 * q + 1]; }
#pragma unroll 4
        for (int i = 0; i < 16; ++i) {
            const int s = 16 * w + i; const unsigned* pr = (const unsigned*)(P + (size_t)(m0 + s) * PW + 2560) + lane;
            float x[8]; float sum = 0.f, sq = 0.f;
#pragma unroll
            for (int q = 0; q < 4; ++q) { const unsigned r = pr[64 * q]; x[2 * q] = bflo(r); x[2 * q + 1] = bfhi(r); }
#pragma unroll
            for (int j = 0; j < 8; ++j) { sum += x[j]; sq += x[j] * x[j]; }
            sum = wave_sum(sum); sq = wave_sum(sq);
            const float mean = sum * (1.0f / CC), var = fmaxf(sq * (1.0f / CC) - mean * mean, 0.f), rstd = 1.0f / sqrtf(var + EPS);
            LAS unsigned* dst = (LAS unsigned*)(lds + s * VPITCH) + lane;
#pragma unroll
            for (int q = 0; q < 4; ++q) dst[64 * q] = pk2((x[2 * q] - mean) * rstd * gv[2 * q] + bv[2 * q], (x[2 * q + 1] - mean) * rstd * gv[2 * q + 1] + bv[2 * q + 1]);
        }
    }
    __syncthreads();
    const int h = w;
    bf16x8 bfr[4][4];
#pragma unroll
    for (int k = 0; k < 4; ++k)
#pragma unroll
        for (int nt = 0; nt < 4; ++nt) {
            const int ch = 64 * h + 16 * (fr >> 2) + 4 * nt + (fr & 3);
            const LAS unsigned short* p = (const LAS unsigned short*)(lds + (32 * k + 8 * fq) * VPITCH + ch * 2);
            unsigned e[8];
#pragma unroll
            for (int j = 0; j < 8; ++j) e[j] = p[j * (VPITCH / 2)];
            u32x4 pk; pk.x = e[0] | (e[1] << 16); pk.y = e[2] | (e[3] << 16); pk.z = e[4] | (e[5] << 16); pk.w = e[6] | (e[7] << 16);
            bfr[k][nt] = __builtin_bit_cast(bf16x8, pk);
        }
#pragma unroll
    for (int mt = 0; mt < 8; ++mt) {
        f32x4 acc[4];
#pragma unroll
        for (int nt = 0; nt < 4; ++nt) acc[nt] = (f32x4){0.f, 0.f, 0.f, 0.f};
#pragma unroll
        for (int k = 0; k <= (mt >> 1); ++k) {
            const bf16x8 af = *(const bf16x8*)(WSB + ((size_t)(h * 128 + 16 * mt + fr)) * 128 + 32 * k + 8 * fq);
#pragma unroll
            for (int nt = 0; nt < 4; ++nt) acc[nt] = __builtin_amdgcn_mfma_f32_16x16x32_bf16(bfr[k][nt], af, acc[nt], 0, 0, 0);
        }
        const int t = 16 * mt + fr, m = m0 + t; const float bias = a.b_s[h * 128 + t];
        const bf16* pr = P + (size_t)m * PW + 64 * h + 16 * fq;
        float u[16], z[16], y[16];
        { float t8[8]; unpack8(*(const u32x4*)(pr + 2048), t8);
#pragma unroll
          for (int j = 0; j < 8; ++j) u[j] = t8[j];
          unpack8(*(const u32x4*)(pr + 2048 + 8), t8);
#pragma unroll
          for (int j = 0; j < 8; ++j) u[8 + j] = t8[j];
          unpack8(*(const u32x4*)(pr + 3072), t8);
#pragma unroll
          for (int j = 0; j < 8; ++j) z[j] = t8[j];
          unpack8(*(const u32x4*)(pr + 3072 + 8), t8);
#pragma unroll
          for (int j = 0; j < 8; ++j) z[8 + j] = t8[j]; }
#pragma unroll
        for (int nt = 0; nt < 4; ++nt)
#pragma unroll
            for (int jj = 0; jj < 4; ++jj) { const int ix = 4 * nt + jj; y[ix] = u[ix] * silu(z[ix]) * (acc[nt][jj] + bias); }
        bf16* yr = YC + (size_t)m * D + CC + 64 * h + 16 * fq;
        u32x4 o0, o1; o0.x = pk2(y[0], y[1]); o0.y = pk2(y[2], y[3]); o0.z = pk2(y[4], y[5]); o0.w = pk2(y[6], y[7]);
        o1.x = pk2(y[8], y[9]); o1.y = pk2(y[10], y[11]); o1.z = pk2(y[12], y[13]); o1.w = pk2(y[14], y[15]);
        *(u32x4*)yr = o0; *(u32x4*)(yr + 8) = o1;
    }
    __syncthreads();
}
__device__ __forceinline__ void phase3(const Args& a, LAS unsigned char* lds, int bid, int G, int tid) {
    constexpr int NBI = MP / 128, NAI = MP / 64, NSI = NSQ / 8;
    for (int it = bid; it < NBI + NAI + NSI; it += G) {
        if (it < NBI) mixB_item(a, lds, it, tid);
        else if (it < NBI + NAI) mixA_item(a, it - NBI, tid);
        else mixS_item(a, it - NBI - NAI, tid);
    }
}

__device__ __forceinline__ void phase5(const Args& a, int bid, int G, int tid) {
    const int lane = tid & 63, w = tid >> 6, NGW = G * NWAVES;
    const float* ssq = (const float*)(a.ws + WS_SSQ);
    for (int m = bid * NWAVES + w; m < MT; m += NGW) {
        const float part = lane < 16 ? ssq[(size_t)m * 16 + lane] : 0.f;
        const float rstd = 1.0f / sqrtf(wave_sum(part) * (1.0f / D) + EPS);
        f32x4* o = (f32x4*)(a.out + O_Y + (size_t)m * D);
#pragma unroll
        for (int j = 0; j < 4; ++j) { const f32x4 g = ((const f32x4*)a.g_final)[lane + 64 * j]; o[lane + 64 * j] = o[lane + 64 * j] * rstd * g; }
    }
}

__global__ void __launch_bounds__(NTHR, 2) mixer_fwd(Args a) {
    extern __shared__ __attribute__((aligned(16))) unsigned char lds_raw[];
    LAS unsigned char* lds = (LAS unsigned char*)lds_raw;
    volatile LAS unsigned* MISC = (volatile LAS unsigned*)(lds + MISC_OFF);
    const int tid = threadIdx.x, bid = blockIdx.x, G = gridDim.x;
    if (tid < 16) MISC[tid] = 0u;
    __syncthreads();
    const int lo = a.ph_lo, hi = a.ph_hi;
    const bool fused = (hi - lo) > 1;
    XcdBarrier bar; bar.bar = (unsigned*)(a.ws + WS_CTL); bar.x = 0; bar.st = MISC;
    if (fused) bar = xcd_barrier_post((unsigned*)(a.ws + WS_CTL), MISC);
#define IN(k) (lo <= (k) && (k) < hi)
#define SEAM(k) do { if (IN(k) && IN((k) + 1)) xcd_barrier(bar); } while (0)
    if (IN(0)) { phase0(a, lds, bid, G, tid); SEAM(0); }
    if (IN(1)) { phase1(a, bid, G, tid); SEAM(1); }
    if (IN(2)) {
        pg8::Gemm g{(const pg8::bf16_t*)(a.ws + WS_H), (const pg8::bf16_t*)(a.ws + WS_W1T), MT, PW, D};
        pg8::StaticOrder S; S.init(MT, PW, G, bid);
        pg8::EpiBf16<0> E{(pg8::bf16_t*)(a.ws + WS_P), PW, nullptr, 0, 0};
        pg8::gemm_phase<pg8::EpiBf16<0>, pg8::StaticOrder, false>(lds, g, S, E, nullptr);
        SEAM(2);
    }
    if (IN(3)) { phase3(a, lds, bid, G, tid); SEAM(3); }
    if (IN(4)) {
        pg8::Gemm g{(const pg8::bf16_t*)(a.ws + WS_YC), (const pg8::bf16_t*)(a.ws + WS_W2T), MT, D, D};
        pg8::StaticOrder S; S.init(MT, D, G, bid);
        pg8::EpiOut E{a.x_prompt, a.x_sample, (const float*)(a.ws + WS_MOD), a.out, (float*)(a.ws + WS_SSQ), MP};
        pg8::gemm_phase<pg8::EpiOut, pg8::StaticOrder, false>(lds, g, S, E, nullptr);
        SEAM(4);
    }
    if (IN(5)) phase5(a, bid, G, tid);
#undef IN
#undef SEAM
}

#ifndef N_LAUNCHES
#define N_LAUNCHES 1
#endif
extern "C" void kernel_launch(void* const* d_in, const int* in_sizes, int n_in, void* d_out, int out_size, void* d_ws, size_t ws_size, hipStream_t stream) {
    static int grid = 0;
    if (grid == 0) {
        if (n_in != 16 || ws_size < WS_END) { fprintf(stderr, "kernel_launch: unexpected inputs (n_in %d, ws %zu)\n", n_in, ws_size); grid = -1; return; }
        int dev = 0, cus = 0, per_cu = 0;
        (void)hipGetDevice(&dev); (void)hipDeviceGetAttribute(&cus, hipDeviceAttributeMultiprocessorCount, dev);
        if (hipFuncSetAttribute((const void*)mixer_fwd, hipFuncAttributeMaxDynamicSharedMemorySize, LDS_BYTES) != hipSuccess) { fprintf(stderr, "kernel_launch: hipFuncSetAttribute failed\n"); grid = -1; return; }
        if (hipOccupancyMaxActiveBlocksPerMultiprocessor(&per_cu, (const void*)mixer_fwd, NTHR, LDS_BYTES) != hipSuccess || per_cu < 1) { fprintf(stderr, "kernel_launch: occupancy query says %d\n", per_cu); per_cu = 1; }
        (void)hipGetLastError();
        grid = cus * 1;
    }
    if (grid < 0) return;
    Args a{};
    const float** ap = (const float**)&a;
    for (int i = 0; i < 16; ++i) ap[i] = (const float*)d_in[i];
    a.out = (float*)d_out; a.ws = (unsigned char*)d_ws;
    if (N_LAUNCHES == 1) {
        (void)hipMemsetAsync((char*)d_ws + WS_CTL, 0, XCD_BAR_WORDS * 4, stream);
        a.ph_lo = 0; a.ph_hi = 6;
        void* args[] = {&a};
        hipError_t e = hipLaunchCooperativeKernel((const void*)mixer_fwd, dim3(grid), dim3(NTHR), args, LDS_BYTES, stream);
        if (e != hipSuccess) fprintf(stderr, "kernel_launch: cooperative launch failed: %s (grid %d)\n", hipGetErrorString(e), grid);
    } else {
        for (int p = 0; p < 6; ++p) { a.ph_lo = p; a.ph_hi = p + 1; hipLaunchKernelGGL(mixer_fwd, dim3(grid), dim3(NTHR), LDS_BYTES, stream, a); }
    }
}
```
